# Optimizing an MI355X kernel written in HIP

```python
import math
import jax, jax.numpy as jnp
from jax import lax
import numpy as np

D_MODEL = 1024
BATCH = 32
SEQ = 2048
DEPTH = 1

MEM_LEN = 256
D_MIX = D_MODEL
HEAD_DIM = 64
ATTN_HEADS = 8
D_ATTN = ATTN_HEADS * HEAD_DIM
CONV_GROUPS = 8
D_CONV = D_MIX - D_ATTN
CONV_WIDTH = 3
MOBA_BLOCK = 256
MOBA_TOPK = 3
Q_CHUNK = 128
MEM_HEADS = 4
MEM_HEAD_DIM = D_MODEL // MEM_HEADS
D_FF = ((8 * D_MODEL // 3) + 127) // 128 * 128
FFN_CONV_WIDTH = 3
EPS = 1e-6
D_IN_MIX = 3 * D_ATTN + 3 * D_CONV

kernel_name = "hymba_moba_shortconv_convffn_layer"


def rmsnorm(x, g):
    xf = x.astype(jnp.float32)
    r = lax.rsqrt(jnp.mean(xf * xf, axis=-1, keepdims=True) + EPS)
    return (xf * r).astype(x.dtype) * g


def causal_dwconv(x, w):
    K = w.shape[0]
    S = x.shape[1]
    xp = jnp.pad(x, ((0, 0), (K - 1, 0), (0, 0)))
    y = xp[:, 0:S] * w[0]
    for k in range(1, K):
        y = y + xp[:, k:k + S] * w[k]
    return y


def moba_attention(q, k, v):
    B, S, H, Dh = q.shape
    L = MOBA_BLOCK
    nb = -(-S // L)
    pad = nb * L - S
    topk = max(1, min(MOBA_TOPK, nb - 1))
    scale = Dh ** -0.5
    kp = jnp.pad(k, ((0, 0), (0, pad), (0, 0), (0, 0)))
    vp = jnp.pad(v, ((0, 0), (0, pad), (0, 0), (0, 0)))
    kb = kp.reshape(B, nb, L, H, Dh).transpose(0, 3, 1, 2, 4)
    vb = vp.reshape(B, nb, L, H, Dh).transpose(0, 3, 1, 2, 4)
    kmean = jnp.mean(kb.astype(jnp.float32), axis=3)

    pos = jnp.arange(S)
    qblk = pos // L
    gate = jnp.einsum('bshd,bhnd->bhsn', q.astype(jnp.float32), kmean)
    past = jnp.arange(nb)[None, :] < qblk[:, None]
    gate = jnp.where(past[None, None], gate, -jnp.inf)
    _, sel = lax.top_k(gate, topk)

    nc = S // Q_CHUNK
    qc = q.reshape(B, nc, Q_CHUNK, H, Dh).transpose(0, 1, 3, 2, 4).reshape(B * nc, H, Q_CHUNK, Dh)
    selc = sel.reshape(B, H, nc, Q_CHUNK, topk).transpose(0, 2, 1, 3, 4).reshape(B * nc, H, Q_CHUNK, topk)

    def one_chunk(args):
        i, q_c, sel_c = args
        b = i // nc
        c = i % nc
        k_b = kb[b]
        v_b = vb[b]
        qpos = c * Q_CHUNK + jnp.arange(Q_CHUNK)
        own = (c * Q_CHUNK) // L
        k_sel = jax.vmap(lambda kh, sh: kh[sh])(k_b, sel_c)
        v_sel = jax.vmap(lambda vh, sh: vh[sh])(v_b, sel_c)
        s_sel = jnp.einsum('hcd,hcjld->hcjl', q_c, k_sel).astype(jnp.float32) * scale
        ok_sel = jnp.arange(topk)[None, :] < (qpos // L)[:, None]
        s_sel = jnp.where(ok_sel[None, :, :, None], s_sel, -jnp.inf)
        k_own = lax.dynamic_index_in_dim(k_b, own, axis=1, keepdims=False)
        v_own = lax.dynamic_index_in_dim(v_b, own, axis=1, keepdims=False)
        s_own = jnp.einsum('hcd,hld->hcl', q_c, k_own).astype(jnp.float32) * scale
        kpos = own * L + jnp.arange(L)
        s_own = jnp.where((kpos[None, :] <= qpos[:, None])[None], s_own, -jnp.inf)
        s = jnp.concatenate([s_sel.reshape(H, Q_CHUNK, topk * L), s_own], axis=-1)
        p = jax.nn.softmax(s, axis=-1).astype(v_b.dtype)
        p_sel = p[..., :topk * L].reshape(H, Q_CHUNK, topk, L)
        p_own = p[..., topk * L:]
        o = jnp.einsum('hcjl,hcjld->hcd', p_sel, v_sel) + jnp.einsum('hcl,hld->hcd', p_own, v_own)
        return o

    out = lax.map(one_chunk, (jnp.arange(B * nc, dtype=jnp.int32), qc, selc))
    return out.reshape(B, nc, H, Q_CHUNK, Dh).transpose(0, 1, 3, 2, 4).reshape(B, S, H, Dh)


def parallel_mixer(h, w_in, conv_w, attn_g, conv_g, w_out):
    B, S, _ = h.shape
    proj = h @ w_in
    o1 = D_ATTN
    o2 = 2 * D_ATTN
    o3 = 3 * D_ATTN
    o4 = o3 + D_CONV
    o5 = o4 + D_CONV
    q, k, v, bg, cg, u = jnp.split(proj, [o1, o2, o3, o4, o5], axis=-1)
    q = q.reshape(B, S, ATTN_HEADS, HEAD_DIM)
    k = k.reshape(B, S, ATTN_HEADS, HEAD_DIM)
    v = v.reshape(B, S, ATTN_HEADS, HEAD_DIM)
    y_attn = moba_attention(q, k, v).reshape(B, S, D_ATTN)
    y_conv = bg * causal_dwconv(cg * u, conv_w)
    y = jnp.concatenate([rmsnorm(y_attn, attn_g), rmsnorm(y_conv, conv_g)], axis=-1)
    return y @ w_out


def memory_cross_attention(h, m, w_q, w_kv, w_o):
    B, S, _ = h.shape
    M = m.shape[1]
    q = (h @ w_q).reshape(B, S, MEM_HEADS, MEM_HEAD_DIM)
    kv = m @ w_kv
    k = kv[..., :D_MODEL].reshape(B, M, MEM_HEADS, MEM_HEAD_DIM)
    v = kv[..., D_MODEL:].reshape(B, M, MEM_HEADS, MEM_HEAD_DIM)
    s = jnp.einsum('bshd,bmhd->bhsm', q, k).astype(jnp.float32) * (MEM_HEAD_DIM ** -0.5)
    p = jax.nn.softmax(s, axis=-1).astype(v.dtype)
    o = jnp.einsum('bhsm,bmhd->bshd', p, v).reshape(B, S, D_MODEL)
    return o @ w_o


def conv_gated_mlp(h, w_up, conv_w, w_down):
    up = h @ w_up
    g = causal_dwconv(up[..., :D_FF], conv_w)
    u = up[..., D_FF:]
    return (jax.nn.silu(g) * u) @ w_down


def setup_inputs(seed: int = 0) -> dict:
    key = jax.random.key(seed)
    ks = jax.random.split(key, 20)
    f32 = jnp.float32

    def w(k, shape, fan_in):
        return jax.random.normal(k, shape, f32) * (fan_in ** -0.5)

    def gain(k, shape):
        return 1.0 + 0.1 * jax.random.normal(k, shape, f32)

    return {
        "x": jax.random.normal(ks[0], (BATCH, SEQ, D_MODEL), f32),
        "mem": jax.random.normal(ks[1], (BATCH, MEM_LEN, D_MODEL), f32),
        "norm_mix_g": gain(ks[2], (DEPTH, D_MODEL)),
        "w_in_mix": w(ks[3], (DEPTH, D_MODEL, D_IN_MIX), D_MODEL),
        "conv_mix_w": w(ks[4], (DEPTH, CONV_WIDTH, D_CONV), CONV_WIDTH),
        "attn_out_g": gain(ks[5], (DEPTH, D_ATTN)),
        "conv_out_g": gain(ks[6], (DEPTH, D_CONV)),
        "w_out_mix": w(ks[7], (DEPTH, D_MIX, D_MODEL), D_MIX),
        "norm_mem_g": gain(ks[8], (DEPTH, D_MODEL)),
        "mem_kv_norm_g": gain(ks[9], (DEPTH, D_MODEL)),
        "w_mem_q": w(ks[10], (DEPTH, D_MODEL, D_MODEL), D_MODEL),
        "w_mem_kv": w(ks[11], (DEPTH, D_MODEL, 2 * D_MODEL), D_MODEL),
        "w_mem_o": w(ks[12], (DEPTH, D_MODEL, D_MODEL), D_MODEL),
        "norm_ffn_g": gain(ks[13], (DEPTH, D_MODEL)),
        "w_ffn_up": w(ks[14], (DEPTH, D_MODEL, 2 * D_FF), D_MODEL),
        "ffn_conv_w": w(ks[15], (DEPTH, FFN_CONV_WIDTH, D_FF), FFN_CONV_WIDTH),
        "w_ffn_down": w(ks[16], (DEPTH, D_FF, D_MODEL), D_FF),
        "final_norm_g": gain(ks[17], (D_MODEL,)),
    }


def reference(x, mem, norm_mix_g, w_in_mix, conv_mix_w, attn_out_g, conv_out_g,
              w_out_mix, norm_mem_g, mem_kv_norm_g, w_mem_q, w_mem_kv, w_mem_o,
              norm_ffn_g, w_ffn_up, ffn_conv_w, w_ffn_down, final_norm_g):
    for l in range(DEPTH):
        h = rmsnorm(x, norm_mix_g[l])
        x = x + parallel_mixer(h, w_in_mix[l], conv_mix_w[l], attn_out_g[l],
                               conv_out_g[l], w_out_mix[l])
        h = rmsnorm(x, norm_mem_g[l])
        m = rmsnorm(mem, mem_kv_norm_g[l])
        x = x + memory_cross_attention(h, m, w_mem_q[l], w_mem_kv[l], w_mem_o[l])
        h = rmsnorm(x, norm_ffn_g[l])
        x = x + conv_gated_mlp(h, w_ffn_up[l], ffn_conv_w[l], w_ffn_down[l])
    return rmsnorm(x, final_norm_g)
```

```cpp
#include <hip/hip_runtime.h>
#include <cstdio>
#include <cstdint>
#include <cmath>
namespace pg8 {
#define PG8_LAS __attribute__((address_space(3)))
typedef unsigned short bf16_t;
typedef short bf16x8 __attribute__((ext_vector_type(8)));
typedef float f32x4 __attribute__((ext_vector_type(4)));
typedef unsigned u32x4 __attribute__((ext_vector_type(4)));
constexpr int BM = 256, BK = 64, HALF = 128, HTB = HALF * BK * 2  , STAGE_BYTES = 8 * HTB, NXCD = 8, WGM = 8;

__host__ __device__ __forceinline__ int lds_byte(int r, int c) { const int st = (r >> 4) * 2 + (c >> 5), rr = r & 15, cc = c & 31, ob = rr * 64 + cc * 2; return st * 1024 + (ob ^ (((ob >> 9) & 1) << 5)); }
__host__ __device__ __forceinline__ void stage_rc(int b, int& R, int& C) { const int st = b / 1024, sb = b % 1024, swz = sb ^ (((sb >> 9) & 1) << 5); R = (st >> 1) * 16 + swz / 64; C = (st & 1) * 32 + (swz % 64) / 2; }
__host__ __device__ __forceinline__ int perm32(int rho) { const int n = rho >> 4, i = rho & 15; return 8 * (i >> 2) + 4 * n + (i & 3); }

struct Unit { int pm, pn; };
struct Gemm { const bf16_t* A; const bf16_t* Bt; int M, N, K; };

struct StaticOrder {
    int nM, nN, nwg, G, c;
    __host__ __device__ void init(int M, int N, int G_, int c_) { nM = M / BM; nN = N / BM; nwg = nM * nN; G = G_; c = c_; }
    __host__ __device__ bool next(int i, Unit& u) const {
        const long L = (long)i * G + c; if (L >= nwg) return false;
        int wgid = (int)L; { const int q = nwg / NXCD, r = nwg % NXCD, xcd = wgid % NXCD, off = wgid / NXCD; wgid = (xcd < r ? xcd * (q + 1) : r * (q + 1) + (xcd - r) * q) + off; }
        const int nig = WGM * nN, gid = wgid / nig, fm = gid * WGM, gsz = (nM - fm) < WGM ? (nM - fm) : WGM;
        u.pm = fm + ((wgid % nig) % gsz); u.pn = (wgid % nig) / gsz; return true;
    }
    __device__ __forceinline__ void a_ready(const Unit&) const {}
    __device__ __forceinline__ void done(const Unit&) const {}
};

__device__ __forceinline__ unsigned cvt_pk_bf16(float lo, float hi) { unsigned r; asm volatile("v_cvt_pk_bf16_f32 %0, %1, %2" : "=v"(r) : "v"(lo), "v"(hi)); return r; }
__device__ __forceinline__ void row_scales(float (&rsv)[2][4], const float* ss, float inv_n, float eps, int row0) {
#pragma unroll
    for (int ai = 0; ai < 2; ++ai)
#pragma unroll
        for (int m = 0; m < 4; ++m) rsv[ai][m] = ss ? (1.0f / sqrtf(ss[row0 + ai * HALF + m * 16] * inv_n + eps)) : 1.0f;
}
struct EpiScaleBf16 {
    static constexpr bool PERM = true, AFTER_DRAIN = false;
    bf16_t* O; int ldc; int split_cols; size_t split_stride; float scale0, scale1;
    const float* ss; float inv_n, eps;
    float* ksum; int k_pn_lo, k_pn_hi, k_ld;
    __device__ __forceinline__ void operator()(const f32x4 (&acc)[2][2][4][2], const Unit& u, int wr, int wc, int fr, int fq) const {
        const int row0 = u.pm * BM + wr * 64 + fr; int colt = u.pn * BM; bf16_t* base = O;
        float sc = scale1; if (split_cols) { const int t = colt / split_cols; base += (size_t)t * split_stride; colt -= t * split_cols; if (t == 0) sc = scale0; }
        const int col0 = colt + wc * 32 + 8 * fq;
        float rsv[2][4]; row_scales(rsv, ss, inv_n, eps, row0);
        const bool do_k = ksum && u.pn >= k_pn_lo && u.pn < k_pn_hi;
        f32x4 cs[2][2];
#pragma unroll
        for (int bj = 0; bj < 2; ++bj)
#pragma unroll
            for (int n = 0; n < 2; ++n) cs[bj][n] = (f32x4){0.f, 0.f, 0.f, 0.f};
#pragma unroll
        for (int ai = 0; ai < 2; ++ai)
#pragma unroll
            for (int m = 0; m < 4; ++m) { bf16_t* rowp = base + (size_t)(row0 + ai * HALF + m * 16) * ldc + col0; const float rs = rsv[ai][m] * sc;
#pragma unroll
                for (int bj = 0; bj < 2; ++bj) { const f32x4 v0 = acc[ai][bj][m][0] * rs, v1 = acc[ai][bj][m][1] * rs;
                    cs[bj][0] += v0; cs[bj][1] += v1;
                    u32x4 w; w.x = cvt_pk_bf16(v0[0], v0[1]); w.y = cvt_pk_bf16(v0[2], v0[3]); w.z = cvt_pk_bf16(v1[0], v1[1]); w.w = cvt_pk_bf16(v1[2], v1[3]);
                    *(u32x4*)(rowp + bj * HALF) = w; } }
        if (do_k) {
#pragma unroll
            for (int bj = 0; bj < 2; ++bj)
#pragma unroll
                for (int n = 0; n < 2; ++n) { f32x4 s = cs[bj][n];
#pragma unroll
                    for (int o = 1; o < 16; o <<= 1) { s[0] += __shfl_xor(s[0], o); s[1] += __shfl_xor(s[1], o); s[2] += __shfl_xor(s[2], o); s[3] += __shfl_xor(s[3], o); }
                    if (fr == 0) *(f32x4*)(ksum + (size_t)(u.pm * 2 + wr) * k_ld + (u.pn - k_pn_lo) * BM + bj * HALF + wc * 32 + 8 * fq + 4 * n) = s; }
        }
    }
};
struct EpiUpSplit {
    static constexpr bool PERM = true, AFTER_DRAIN = false;
    bf16_t* Gp; bf16_t* Up; int ldc; const float* ss; float inv_n, eps;
    __device__ __forceinline__ void operator()(const f32x4 (&acc)[2][2][4][2], const Unit& u, int wr, int wc, int fr, int fq) const {
        const int row0 = u.pm * BM + wr * 64 + fr, col0 = u.pn * HALF + wc * 32 + 8 * fq;
        float rsv[2][4]; row_scales(rsv, ss, inv_n, eps, row0);
#pragma unroll
        for (int ai = 0; ai < 2; ++ai)
#pragma unroll
            for (int m = 0; m < 4; ++m) { const size_t off = (size_t)(row0 + ai * HALF + m * 16) * ldc + col0; const float rs = rsv[ai][m];
#pragma unroll
                for (int bj = 0; bj < 2; ++bj) { const f32x4 v0 = acc[ai][bj][m][0] * rs, v1 = acc[ai][bj][m][1] * rs;
                    u32x4 w; w.x = cvt_pk_bf16(v0[0], v0[1]); w.y = cvt_pk_bf16(v0[2], v0[3]); w.z = cvt_pk_bf16(v1[0], v1[1]); w.w = cvt_pk_bf16(v1[2], v1[3]);
                    *(u32x4*)((bj == 0 ? Gp : Up) + off) = w; } }
    }
};
struct EpiResid {
    static constexpr bool PERM = true, AFTER_DRAIN = false;
    const float* base; float* out; int ldc; bf16_t* ob; float* ssq;
    __device__ __forceinline__ void operator()(const f32x4 (&acc)[2][2][4][2], const Unit& u, int wr, int wc, int fr, int fq) const {
        const int row0 = u.pm * BM + wr * 64 + fr, col0 = u.pn * BM + wc * 32 + 8 * fq;
#pragma unroll
        for (int ai = 0; ai < 2; ++ai)
#pragma unroll
            for (int m = 0; m < 4; ++m) { const int row = row0 + ai * HALF + m * 16; const size_t off = (size_t)row * ldc + col0; float q = 0.f;
#pragma unroll
                for (int bj = 0; bj < 2; ++bj) {
                    const f32x4 b0 = *(const f32x4*)(base + off + bj * HALF), b1 = *(const f32x4*)(base + off + bj * HALF + 4);
                    const f32x4 v0 = b0 + acc[ai][bj][m][0], v1 = b1 + acc[ai][bj][m][1];
                    *(f32x4*)(out + off + bj * HALF) = v0; *(f32x4*)(out + off + bj * HALF + 4) = v1;
                    q += (v0[0] * v0[0] + v0[1] * v0[1]) + (v0[2] * v0[2] + v0[3] * v0[3]) + (v1[0] * v1[0] + v1[1] * v1[1]) + (v1[2] * v1[2] + v1[3] * v1[3]);
                    if (ob) { u32x4 w; w.x = cvt_pk_bf16(v0[0], v0[1]); w.y = cvt_pk_bf16(v0[2], v0[3]); w.z = cvt_pk_bf16(v1[0], v1[1]); w.w = cvt_pk_bf16(v1[2], v1[3]);
                        *(u32x4*)(ob + off + bj * HALF) = w; } }
                if (ssq) { q += __shfl_xor(q, 16); q += __shfl_xor(q, 32); if (fq == 0) atomicAdd(ssq + row, q); }
                if (m & 1) asm volatile("" ::: "memory"); }
    }
};

template <class Epi, class Sched, bool ALIGN_EPI = false, bool SP2 = false>
__device__ __forceinline__ void gemm_phase(PG8_LAS unsigned char* lds, const Gemm g, const Sched& S, const Epi& E) {
    const int tid = threadIdx.x, wid = __builtin_amdgcn_readfirstlane(tid >> 6), lane = tid & 63, wr = wid >> 2, wc = wid & 3, fr = lane & 15, fq = lane >> 4;
    const int K = g.K, nt = K / BK;
    unsigned voffA[2], voffB[2];
#pragma unroll
    for (int i = 0; i < 2; ++i) { int R, C; stage_rc(tid * 16 + i * 8192, R, C); const int Rb = Epi::PERM ? ((R & ~31) + perm32(R & 31)) : R;
        voffA[i] = (unsigned)(R * K + C) * 2u; voffB[i] = (unsigned)(Rb * K + C) * 2u; }
    const size_t kstep = (size_t)(BK * 2);
    const size_t hstep = (size_t)HALF * K * 2;
    const size_t tstep = 2 * hstep;
    const unsigned ldsw = (unsigned)wid * 1024u;
    const int aoff = lds_byte(wr * 64 + fr, fq * 8), boff = lds_byte(wc * 32 + fr, fq * 8);
#define PG8_SA(b, h) (((b) * 2 + (h)) * HTB)
#define PG8_SB(b, h) ((4 + (b) * 2 + (h)) * HTB)
#define PG8_STAGE(bufoff, gbase, voff) do { _Pragma("unroll") for (int _i = 0; _i < 2; ++_i) \
        __builtin_amdgcn_global_load_lds((const unsigned*)((const char*)(gbase) + (voff)[_i]), (PG8_LAS unsigned*)(lds + (bufoff) + ldsw + _i * 8192), 16, 0, 0); } while (0)
#define PG8_LDA(dst, b, h) do { _Pragma("unroll") for (int m = 0; m < 4; ++m) _Pragma("unroll") for (int k = 0; k < 2; ++k) dst[m][k] = *(const PG8_LAS bf16x8*)(lds + PG8_SA(b, h) + aoff + m * 2048 + k * 1024); } while (0)
#define PG8_LDB(dst, b, h) do { _Pragma("unroll") for (int n = 0; n < 2; ++n) _Pragma("unroll") for (int k = 0; k < 2; ++k) dst[n][k] = *(const PG8_LAS bf16x8*)(lds + PG8_SB(b, h) + boff + n * 2048 + k * 1024); } while (0)
#define PG8_MMA(ai, bj, At, Bt) do { __builtin_amdgcn_s_setprio(1); _Pragma("unroll") for (int m = 0; m < 4; ++m) _Pragma("unroll") for (int n = 0; n < 2; ++n) _Pragma("unroll") for (int k = 0; k < 2; ++k) \
        acc[ai][bj][m][n] = __builtin_amdgcn_mfma_f32_16x16x32_bf16(Bt[n][k], At[m][k], acc[ai][bj][m][n], 0, 0, 0); __builtin_amdgcn_s_setprio(0); } while (0)
#define PG8_WAIT_V(n) asm volatile("s_waitcnt vmcnt(" #n ")" ::: "memory")
#define PG8_WAIT_L(n) asm volatile("s_waitcnt lgkmcnt(" #n ")" ::: "memory")
#define PG8_BAR __builtin_amdgcn_s_barrier()
#define PG8_SCHED __builtin_amdgcn_sched_barrier(0)
    Unit cur, nxt; int ui = 0;
    if (!S.next(0, cur)) return;
    f32x4 acc[2][2][4][2];
#pragma unroll
    for (int a = 0; a < 2; ++a)
#pragma unroll
        for (int b = 0; b < 2; ++b)
#pragma unroll
            for (int m = 0; m < 4; ++m)
#pragma unroll
                for (int n = 0; n < 2; ++n) acc[a][b][m][n] = (f32x4){0.f, 0.f, 0.f, 0.f};
    bf16x8 At[4][2], B0[2][2], B1[2][2];
    const char* cA = (const char*)g.A + (size_t)cur.pm * tstep; const char* cB = (const char*)g.Bt + (size_t)cur.pn * tstep;
    S.a_ready(cur);
    if constexpr (SP2) {
        PG8_STAGE(PG8_SB(0, 0), cB, voffB); PG8_STAGE(PG8_SB(0, 1), cB + hstep, voffB); PG8_STAGE(PG8_SA(0, 0), cA, voffA); PG8_STAGE(PG8_SA(0, 1), cA + hstep, voffA);
        if (wr == 1) PG8_BAR;
        PG8_WAIT_V(2); PG8_BAR;
        PG8_STAGE(PG8_SB(1, 0), cB + kstep, voffB); PG8_STAGE(PG8_SA(1, 0), cA + kstep, voffA); PG8_STAGE(PG8_SB(1, 1), cB + hstep + kstep, voffB);
        PG8_WAIT_V(6); PG8_BAR;
    } else {
        PG8_STAGE(PG8_SB(0, 0), cB, voffB); PG8_STAGE(PG8_SA(0, 0), cA, voffA); PG8_STAGE(PG8_SB(0, 1), cB + hstep, voffB); PG8_STAGE(PG8_SA(0, 1), cA + hstep, voffA);
        if (wr == 1) PG8_BAR;
        PG8_WAIT_V(4); PG8_BAR;
        PG8_STAGE(PG8_SB(1, 0), cB + kstep, voffB); PG8_STAGE(PG8_SA(1, 0), cA + kstep, voffA); PG8_STAGE(PG8_SB(1, 1), cB + hstep + kstep, voffB);
        PG8_WAIT_V(6); PG8_BAR;
    }
    for (;;) {
        const bool has_next = S.next(ui + 1, nxt);
        const char* nA = has_next ? (const char*)g.A + (size_t)nxt.pm * tstep : cA; const char* nB = has_next ? (const char*)g.Bt + (size_t)nxt.pn * tstep : cB;
        for (int t = 0; t < nt; t += 2) {
            const bool last = (t == nt - 2);
            const char* a1 = cA + (size_t)(t + 1) * kstep;
            const char* a2 = last ? nA : cA + (size_t)(t + 2) * kstep; const char* b2 = last ? nB : cB + (size_t)(t + 2) * kstep;
            const char* a3 = a2 + kstep; const char* b3 = b2 + kstep;
            if (last && has_next) S.a_ready(nxt);
            if constexpr (SP2) {
            PG8_LDB(B0, 0, 0); PG8_LDB(B1, 0, 1); PG8_SCHED; PG8_LDA(At, 0, 0); PG8_STAGE(PG8_SA(1, 1), a1 + hstep, voffA);
            PG8_WAIT_V(8); PG8_WAIT_L(0); PG8_BAR; PG8_MMA(0, 0, At, B0); PG8_MMA(0, 1, At, B1); PG8_BAR; PG8_SCHED;
            PG8_LDA(At, 0, 1); PG8_STAGE(PG8_SB(0, 0), b2, voffB); PG8_STAGE(PG8_SB(0, 1), b2 + hstep, voffB); PG8_STAGE(PG8_SA(0, 0), a2, voffA);
            PG8_WAIT_V(8); PG8_WAIT_L(0); PG8_BAR; PG8_MMA(1, 0, At, B0); PG8_MMA(1, 1, At, B1); PG8_BAR; PG8_SCHED;
            PG8_LDB(B0, 1, 0); PG8_LDB(B1, 1, 1); PG8_SCHED; PG8_LDA(At, 1, 0); PG8_STAGE(PG8_SA(0, 1), a2 + hstep, voffA);
            PG8_WAIT_V(8); PG8_WAIT_L(0); PG8_BAR; PG8_MMA(0, 0, At, B0); PG8_MMA(0, 1, At, B1); PG8_BAR; PG8_SCHED;
            PG8_LDA(At, 1, 1); PG8_STAGE(PG8_SB(1, 0), b3, voffB); PG8_STAGE(PG8_SB(1, 1), b3 + hstep, voffB); PG8_STAGE(PG8_SA(1, 0), a3, voffA);
            PG8_WAIT_V(8); PG8_WAIT_L(0); PG8_BAR; PG8_MMA(1, 0, At, B0); PG8_MMA(1, 1, At, B1); PG8_BAR; PG8_SCHED;
            } else {
            PG8_LDB(B0, 0, 0); PG8_SCHED; PG8_LDA(At, 0, 0); PG8_STAGE(PG8_SA(1, 1), a1 + hstep, voffA);
            PG8_WAIT_L(8); PG8_BAR; PG8_WAIT_L(0); PG8_MMA(0, 0, At, B0); PG8_BAR; PG8_SCHED;
            PG8_LDB(B1, 0, 1); PG8_STAGE(PG8_SB(0, 0), b2, voffB);
            PG8_BAR; PG8_WAIT_L(0); PG8_MMA(0, 1, At, B1); PG8_BAR;
            PG8_LDA(At, 0, 1); PG8_STAGE(PG8_SA(0, 0), a2, voffA);
            PG8_BAR; PG8_WAIT_L(0); PG8_MMA(1, 0, At, B0); PG8_BAR; PG8_SCHED;
            PG8_STAGE(PG8_SB(0, 1), b2 + hstep, voffB);
            PG8_WAIT_V(6); PG8_BAR; PG8_MMA(1, 1, At, B1); PG8_BAR;
            PG8_LDB(B0, 1, 0); PG8_SCHED; PG8_LDA(At, 1, 0); PG8_STAGE(PG8_SA(0, 1), a2 + hstep, voffA);
            PG8_WAIT_L(8); PG8_BAR; PG8_WAIT_L(0); PG8_MMA(0, 0, At, B0); PG8_BAR; PG8_SCHED;
            PG8_LDB(B1, 1, 1); PG8_STAGE(PG8_SB(1, 0), b3, voffB);
            PG8_BAR; PG8_WAIT_L(0); PG8_MMA(0, 1, At, B1); PG8_BAR;
            PG8_LDA(At, 1, 1); PG8_STAGE(PG8_SA(1, 0), a3, voffA);
            PG8_BAR; PG8_WAIT_L(0); PG8_MMA(1, 0, At, B0); PG8_BAR; PG8_SCHED;
            PG8_STAGE(PG8_SB(1, 1), b3 + hstep, voffB);
            PG8_WAIT_V(6); PG8_BAR; PG8_MMA(1, 1, At, B1); PG8_BAR;
            }
        }
        if constexpr (ALIGN_EPI) { if (wr == 0) PG8_BAR; }
        if constexpr (!Epi::AFTER_DRAIN) { E(acc, cur, wr, wc, fr, fq); S.done(cur); }
        if (!has_next) break;
#pragma unroll
        for (int a = 0; a < 2; ++a)
#pragma unroll
            for (int b = 0; b < 2; ++b)
#pragma unroll
                for (int m = 0; m < 4; ++m)
#pragma unroll
                    for (int n = 0; n < 2; ++n) acc[a][b][m][n] = (f32x4){0.f, 0.f, 0.f, 0.f};
        cur = nxt; cA = nA; cB = nB; ++ui;
        if constexpr (ALIGN_EPI) { if (wr == 1) PG8_BAR; }
    }
    PG8_WAIT_V(0);
    if constexpr (!ALIGN_EPI) { if (wr == 0) PG8_BAR; }
    PG8_BAR;
    if constexpr (Epi::AFTER_DRAIN) { E.fused(acc, cur, wr, wc, fr, fq, lds, wid, lane); S.done(cur); }
#undef PG8_SA
#undef PG8_SB
#undef PG8_STAGE
#undef PG8_LDA
#undef PG8_LDB
#undef PG8_MMA
#undef PG8_WAIT_V
#undef PG8_WAIT_L
#undef PG8_BAR
#undef PG8_SCHED
}
}
constexpr int NWAVES = 8;
#ifndef MK_N_LAUNCHES
#define MK_N_LAUNCHES 11
#endif
constexpr int N_PHASES = 11;
constexpr int N_LAUNCHES = MK_N_LAUNCHES;

constexpr int BATCH = 32, SEQ = 2048, D = 1024, M = BATCH * SEQ;
constexpr int MEMLEN = 256, MM = BATCH * MEMLEN;
constexpr int DA = 512, DC = 512, NIN = 3072, DFF = 2816, NUP = 2 * DFF;
constexpr int MOBA_L = 256, MOBA_NB = SEQ / MOBA_L;
constexpr float EPS = 1e-6f;
constexpr float LOG2E = 1.4426950408889634f;
constexpr float C2A = 0.125f * LOG2E;
constexpr float C2M = 0.0625f * LOG2E;

constexpr size_t MiB = 1u << 20;
constexpr size_t WS_CTL = 0, CTL_ZERO_BYTES = 1 * MiB;
constexpr size_t WS_KSUM = 1 * MiB;
constexpr size_t WS_SS = 2 * MiB;
constexpr size_t WS_WIN = 4 * MiB, WS_WOUT = 10 * MiB, WS_WQ = 12 * MiB, WS_WKV = 14 * MiB, WS_WO = 18 * MiB, WS_WUP = 20 * MiB, WS_WDN = 31 * MiB;
constexpr size_t WS_MN = 40 * MiB;
constexpr size_t WS_KVM = 56 * MiB;
constexpr size_t WS_RB = 96 * MiB;
constexpr size_t WS_RC = 224 * MiB;
constexpr size_t WS_RA = 352 * MiB;
constexpr size_t WS_G = 224 * MiB, WS_U = 576 * MiB;
constexpr size_t WS_END = 928 * MiB;
constexpr size_t QKV_STRIDE = (size_t)M * 512;
static_assert(WS_WDN + (size_t)D * DFF * 2 <= WS_MN && WS_WUP + (size_t)NUP * D * 2 <= WS_WDN && WS_G + (size_t)M * DFF * 2 <= WS_U && WS_U + (size_t)M * DFF * 2 <= WS_END, "d_ws map");
constexpr int CW_TMO = 0, CW_CODE = 1;
constexpr int CW_BAR = 4096;

constexpr int RING_OFF = 0, RING_BYTES = 131072;
constexpr int LDSCTL_OFF = RING_BYTES, MISC_OFF = LDSCTL_OFF + 320;
constexpr int LDS_BYTES = 147456;
static_assert(MISC_OFF + 128 <= LDS_BYTES, "LDS map");

#define GAS __attribute__((address_space(1)))
#define LAS __attribute__((address_space(3)))
typedef unsigned short bf16;
typedef unsigned v4u __attribute__((ext_vector_type(4)));
typedef float f32x4 __attribute__((ext_vector_type(4)));
typedef short bf16x8 __attribute__((ext_vector_type(8)));
typedef GAS unsigned gu32;
typedef GAS unsigned long long gu64;
#define RLX_AGENT __ATOMIC_RELAXED, __HIP_MEMORY_SCOPE_AGENT
#define LDS_WAIT() asm volatile("s_waitcnt lgkmcnt(0)" ::: "memory")
#define VM_WAIT() asm volatile("s_waitcnt vmcnt(0)" ::: "memory")
__device__ __forceinline__ unsigned long long rt() { return __builtin_amdgcn_s_memrealtime(); }
__device__ __forceinline__ unsigned f2bf(float f) { unsigned u = __builtin_bit_cast(unsigned, f); return (u + 0x7fffu + ((u >> 16) & 1u)) >> 16; }
__device__ __forceinline__ unsigned pk2(float lo, float hi) { return f2bf(lo) | (f2bf(hi) << 16); }
#define XB_TMO      128
#define XB_XCNT(j)  (256  + 64 * (j))
#define XB_XSUB(j)  (1280 + 64 * (j))
#define XB_XGEN(j)  (2304 + 64 * (j))
#define XB_TOP      3328
#define XB_TOPGEN   3392
#define XCD_BAR_WORDS 3456
#define XB_SPIN_CAP (1u << 18)

__device__ __forceinline__ unsigned xb_ld(unsigned* p)              { return __hip_atomic_load(p, __ATOMIC_RELAXED, __HIP_MEMORY_SCOPE_AGENT); }
__device__ __forceinline__ unsigned xb_add(unsigned* p, unsigned v) { return __hip_atomic_fetch_add(p, v, __ATOMIC_RELAXED, __HIP_MEMORY_SCOPE_AGENT); }
__device__ __forceinline__ unsigned xb_xcc_id() { return (unsigned)__builtin_amdgcn_s_getreg((3 << 11) | 20) & 0xFu; }
#define XB_SPIN(cond, bar) do { unsigned _sp = 0; while (cond) { __builtin_amdgcn_s_sleep(1); \
    if ((++_sp & 255u) == 0u) { if (xb_ld(&(bar)[XB_TMO])) break; if (_sp > XB_SPIN_CAP) { atomicAdd(&(bar)[XB_TMO], 1u); break; } } } } while (0)

struct XcdBarrier {
    unsigned* bar; unsigned x;
    volatile LAS unsigned* st;
};

__device__ __forceinline__ XcdBarrier xcd_barrier_post(unsigned* bar, volatile LAS unsigned* st) {
    XcdBarrier b; b.bar = bar; b.x = xb_xcc_id(); b.st = st;
    if (threadIdx.x == 0) (void)xb_add(&bar[XB_XCNT(b.x)], 1u);
    return b;
}
__device__ __forceinline__ void xcd_barrier_complete(unsigned* bar, unsigned x, unsigned& nloc, unsigned& nx) {
    const unsigned G = gridDim.x * gridDim.y * gridDim.z;
    unsigned sum, cnt, mine, sp = 0u;
    for (;;) {
        sum = 0u; cnt = 0u; mine = 0u;
#pragma unroll
        for (unsigned j = 0; j < 16; ++j) { const unsigned c = xb_ld(&bar[XB_XCNT(j)]); sum += c; cnt += (c > 0u) ? 1u : 0u; mine = (j == x) ? c : mine; }
        if (sum == G) break;
        __builtin_amdgcn_s_sleep(1);
        if ((++sp & 255u) == 0u) { if (xb_ld(&bar[XB_TMO])) break; if (sp > XB_SPIN_CAP) { atomicAdd(&bar[XB_TMO], 1u); break; } }
    }
    nloc = mine > 0u ? mine : 1u; nx = cnt > 0u ? cnt : 1u;
}

__device__ __forceinline__ void xcd_barrier(const XcdBarrier& b) {
    asm volatile("s_waitcnt vmcnt(0)" ::: "memory");
    __syncthreads();
    if (threadIdx.x == 0) {
        unsigned* bar = b.bar;
        __builtin_amdgcn_s_waitcnt(0);
        unsigned nloc = b.st[0], nx = b.st[1];
        if (nloc == 0u) { xcd_barrier_complete(bar, b.x, nloc, nx); b.st[0] = nloc; b.st[1] = nx; }
        const unsigned old = xb_add(&bar[XB_XSUB(b.x)], 1u);
        const unsigned gen = old / nloc;
        if (old + 1u == (gen + 1u) * nloc) {
            __builtin_amdgcn_fence(__ATOMIC_RELEASE, "agent");
            asm volatile("s_waitcnt vmcnt(0)" ::: "memory");
            const unsigned og = xb_add(&bar[XB_TOP], 1u);
            const unsigned tg = og / nx;
            if (og + 1u == (tg + 1u) * nx) xb_add(&bar[XB_TOPGEN], 1u);
            else XB_SPIN(xb_ld(&bar[XB_TOPGEN]) == tg, bar);
            __builtin_amdgcn_fence(__ATOMIC_ACQUIRE, "agent");
            xb_add(&bar[XB_XGEN(b.x)], 1u);
            asm volatile("s_waitcnt vmcnt(0)" ::: "memory");
        } else {
            XB_SPIN(xb_ld(&bar[XB_XGEN(b.x)]) == gen, bar);
            __builtin_amdgcn_fence(__ATOMIC_ACQUIRE, "agent");
            asm volatile("s_waitcnt vmcnt(0)" ::: "memory");
        }
    }
    __syncthreads();
}
struct Frame {
    LAS unsigned char* lds;
    volatile LAS unsigned* MISC;
    gu32* ctl;
    int tid, lane, wave;
    int vcu, G;
    const float *x, *mem, *g_mix, *w_in, *conv_w, *g_attn, *g_conv, *w_out, *g_mem, *g_kvn, *w_q, *w_kv, *w_o, *g_ffn, *w_up, *ffn_cw, *w_dn, *g_fin;
    float* out;
    float *ksum, *ss0, *ss1, *ss2, *ss3;
    bf16 *WinT, *WoutT, *WqT, *WkvT, *WoT, *WupT, *WdnT;
    bf16 *MN, *KVM, *RB, *RC, *RA, *Gb, *Ub;
};
__device__ __forceinline__ float bflo(unsigned u) { return __uint_as_float(u << 16); }
__device__ __forceinline__ float bfhi(unsigned u) { return __uint_as_float(u & 0xffff0000u); }
__device__ __forceinline__ float bf2f(bf16 u) { return __uint_as_float((unsigned)u << 16); }
__device__ __forceinline__ float wave_sum(float v) {
#pragma unroll
    for (int o = 1; o < 64; o <<= 1) v += __shfl_xor(v, o);
    return v;
}
__device__ __forceinline__ float wave_max(float v) {
#pragma unroll
    for (int o = 1; o < 64; o <<= 1) v = fmaxf(v, __shfl_xor(v, o));
    return v;
}
__device__ __forceinline__ float dot8(v4u a, v4u b) {
    return (bflo(a.x) * bflo(b.x) + bfhi(a.x) * bfhi(b.x)) + (bflo(a.y) * bflo(b.y) + bfhi(a.y) * bfhi(b.y))
         + (bflo(a.z) * bflo(b.z) + bfhi(a.z) * bfhi(b.z)) + (bflo(a.w) * bflo(b.w) + bfhi(a.w) * bfhi(b.w));
}

template <bool UPMAP>
__device__ __forceinline__ void p0_transpose_item(const float* W, int K, int N, bf16* WT, const float* gain, LAS float* scr, int item, int lane) {
    const int nblk = N / 32, kb = item / nblk, nb = item % nblk, k0 = 64 * kb, n0 = 32 * nb;
#pragma unroll 8
    for (int i = 0; i < 32; ++i) { const int kk = 2 * i + (lane >> 5); float w = W[(size_t)(k0 + kk) * N + n0 + (lane & 31)]; if (gain) w *= gain[k0 + kk]; scr[kk * 33 + (lane & 31)] = w; }
    LDS_WAIT(); asm volatile("" ::: "memory");
    const int c = lane & 7;
    int r0 = n0;
    if (UPMAP) { r0 = (n0 < DFF) ? ((n0 >> 7) * 256 + (n0 & 127)) : ((((n0 - DFF) >> 7) * 256) + 128 + ((n0 - DFF) & 127)); }
#pragma unroll
    for (int j = 0; j < 4; ++j) { const int n = (lane >> 3) + 8 * j; const LAS float* s = scr + (8 * c) * 33 + n;
        v4u o; o.x = pk2(s[0 * 33], s[1 * 33]); o.y = pk2(s[2 * 33], s[3 * 33]); o.z = pk2(s[4 * 33], s[5 * 33]); o.w = pk2(s[6 * 33], s[7 * 33]);
        *(GAS v4u*)(WT + (size_t)(r0 + n) * K + k0 + 8 * c) = o; }
    LDS_WAIT(); asm volatile("" ::: "memory");
}
__device__ __forceinline__ void row_to_bf16(const float* xrow, bf16* orow, float* ssp, bool normalize, int lane) {
    const GAS f32x4* xr = (const GAS f32x4*)xrow + lane;
    f32x4 v[4]; float s = 0.f;
#pragma unroll
    for (int j = 0; j < 4; ++j) { v[j] = xr[64 * j]; s += (v[j].x * v[j].x + v[j].y * v[j].y) + (v[j].z * v[j].z + v[j].w * v[j].w); }
    s = wave_sum(s);
    const float r = normalize ? 1.f / sqrtf(s * (1.f / D) + EPS) : 1.f;
    if (ssp && lane == 0) *ssp = s;
    GAS unsigned long long* o8 = (GAS unsigned long long*)orow + lane;
#pragma unroll
    for (int j = 0; j < 4; ++j) o8[64 * j] = (unsigned long long)pk2(v[j].x * r, v[j].y * r) | ((unsigned long long)pk2(v[j].z * r, v[j].w * r) << 32);
}
__device__ __forceinline__ void p0_prologue(Frame& F) {
    LAS float* scr = (LAS float*)(F.lds + RING_OFF + F.wave * 16384);
    const int gw = F.vcu * NWAVES + F.wave, NGW = F.G * NWAVES;
    constexpr int I_IN = (D / 64) * (NIN / 32), I_SQ = (D / 64) * (D / 32), I_KV = (D / 64) * (2 * D / 32), I_UP = (D / 64) * (NUP / 32), I_DN = (DFF / 64) * (D / 32);
    constexpr int NITEMS = I_IN + 3 * I_SQ + I_KV + I_UP + I_DN;
    for (int it = gw; it < NITEMS; it += NGW) {
        int r = it;
        if (r < I_IN) { p0_transpose_item<false>(F.w_in, D, NIN, F.WinT, F.g_mix, scr, r, F.lane); continue; } r -= I_IN;
        if (r < I_SQ) { p0_transpose_item<false>(F.w_out, D, D, F.WoutT, nullptr, scr, r, F.lane); continue; } r -= I_SQ;
        if (r < I_SQ) { p0_transpose_item<false>(F.w_q, D, D, F.WqT, F.g_mem, scr, r, F.lane); continue; } r -= I_SQ;
        if (r < I_KV) { p0_transpose_item<false>(F.w_kv, D, 2 * D, F.WkvT, F.g_kvn, scr, r, F.lane); continue; } r -= I_KV;
        if (r < I_SQ) { p0_transpose_item<false>(F.w_o, D, D, F.WoT, nullptr, scr, r, F.lane); continue; } r -= I_SQ;
        if (r < I_UP) { p0_transpose_item<true>(F.w_up, D, NUP, F.WupT, F.g_ffn, scr, r, F.lane); continue; } r -= I_UP;
        p0_transpose_item<false>(F.w_dn, DFF, D, F.WdnT, nullptr, scr, r, F.lane);
    }
    for (int m = gw; m < M; m += NGW) row_to_bf16(F.x + (size_t)m * D, F.RB + (size_t)m * D, F.ss0 + m, false, F.lane);
    for (int m = gw; m < MM; m += NGW) row_to_bf16(F.mem + (size_t)m * D, F.MN + (size_t)m * D, nullptr, true, F.lane);
    for (int i = (F.vcu * NWAVES * 64) + F.tid; i < 3 * M; i += F.G * NWAVES * 64) F.ss1[i] = 0.f;
}

__device__ __forceinline__ void p2_moba_naive(Frame& F) {
    LAS float* pbuf = (LAS float*)(F.lds + RING_OFF) + F.wave * 2048;
    LAS float* obuf = pbuf + 1024;
    const int gw = F.vcu * NWAVES + F.wave, NGW = F.G * NWAVES, lane = F.lane;
    const bf16* Qb = F.RA; const bf16* Kb = F.RA + QKV_STRIDE; const bf16* Vb = F.RA + 2 * QKV_STRIDE;
    for (int row = gw; row < M; row += NGW) {
        const int b = row >> 11, s = row & 2047, qb = s >> 8;
        float ssq = 0.f;
#pragma unroll 1
        for (int h = 0; h < 8; ++h) {
            const float qd = bf2f(Qb[(size_t)row * 512 + h * 64 + lane]);
            float g[7];
#pragma unroll
            for (int j = 0; j < 7; ++j) {
                float km = 0.f;
                if (j < qb) { const float* kp = F.ksum + (size_t)((b * 8 + j) * 2) * 512 + h * 64 + lane; km = kp[0] + kp[512]; }
                const float gj = wave_sum(qd * km);
                g[j] = (j < qb) ? gj : -INFINITY;
            }
            unsigned mask = 0u;
#pragma unroll
            for (int j = 0; j < 7; ++j) { int cnt = 0;
#pragma unroll
                for (int k = 0; k < 7; ++k) if (k != j) cnt += (g[k] > g[j] || (g[k] == g[j] && k < j)) ? 1 : 0;
                if (j < qb && cnt < 3) mask |= 1u << j; }
            mask |= 1u << qb;
            v4u qv[8];
#pragma unroll
            for (int c = 0; c < 8; ++c) qv[c] = *(const GAS v4u*)(Qb + (size_t)row * 512 + h * 64 + c * 8);
            int nslot = 0; float mx = -INFINITY;
            for (int j = 0; j <= qb; ++j) {
                if (!((mask >> j) & 1u)) continue;
                const bool own = (j == qb);
#pragma unroll
                for (int q4 = 0; q4 < 4; ++q4) {
                    const int kk = lane + 64 * q4, kpos = j * 256 + kk;
                    const bf16* kr = Kb + (size_t)(b * 2048 + kpos) * 512 + h * 64;
                    float dot = 0.f;
#pragma unroll
                    for (int c = 0; c < 8; ++c) dot += dot8(qv[c], *(const GAS v4u*)(kr + c * 8));
                    const float sc = (!own || kpos <= s) ? dot : -INFINITY;
                    pbuf[nslot * 256 + kk] = sc; mx = fmaxf(mx, sc);
                }
                ++nslot;
            }
            mx = wave_max(mx);
            LDS_WAIT(); asm volatile("" ::: "memory");
            float sum = 0.f;
            for (int i = lane; i < nslot * 256; i += 64) { const float p = exp2f(pbuf[i] - mx); pbuf[i] = p; sum += p; }
            sum = wave_sum(sum);
            LDS_WAIT(); asm volatile("" ::: "memory");
            float acc = 0.f; int slot = 0;
            for (int j = 0; j <= qb; ++j) {
                if (!((mask >> j) & 1u)) continue;
                const int nk = (j == qb) ? (s - qb * 256 + 1) : 256;
                const bf16* vr = Vb + (size_t)(b * 2048 + j * 256) * 512 + h * 64 + lane;
                const LAS float* pp = pbuf + slot * 256;
#pragma unroll 8
                for (int kk = 0; kk < nk; ++kk) acc += pp[kk] * bf2f(vr[(size_t)kk * 512]);
                ++slot;
            }
            const float o = acc / sum;
            obuf[h * 64 + lane] = o; ssq += o * o;
            LDS_WAIT(); asm volatile("" ::: "memory");
        }
        ssq = wave_sum(ssq);
        const float r = 1.f / sqrtf(ssq * (1.f / DA) + EPS);
#pragma unroll
        for (int h = 0; h < 8; ++h) { const int c = h * 64 + lane; F.RB[(size_t)row * D + c] = (bf16)f2bf(obuf[c] * r * F.g_attn[c]); }
        LDS_WAIT(); asm volatile("" ::: "memory");
    }
}
__device__ __forceinline__ void p2_conv(Frame& F) {
    const int gw = F.vcu * NWAVES + F.wave, NGW = F.G * NWAVES, lane = F.lane;
    const bf16* Bb = F.RA + 3 * QKV_STRIDE; const bf16* Cb = F.RA + 4 * QKV_STRIDE; const bf16* Ub = F.RA + 5 * QKV_STRIDE;
    const int c0 = lane * 8;
    float w0[8], w1[8], w2[8], gc[8];
#pragma unroll
    for (int j = 0; j < 8; ++j) { w0[j] = F.conv_w[c0 + j]; w1[j] = F.conv_w[DC + c0 + j]; w2[j] = F.conv_w[2 * DC + c0 + j]; gc[j] = F.g_conv[c0 + j]; }
    for (int row = gw; row < M; row += NGW) {
        const int s = row & 2047;
        const size_t off = (size_t)row * 512 + c0;
        const v4u zero = {0u, 0u, 0u, 0u};
        const v4u bv = *(const GAS v4u*)(Bb + off);
        const v4u cv0 = *(const GAS v4u*)(Cb + off), uv0 = *(const GAS v4u*)(Ub + off);
        const v4u cv1 = s >= 1 ? *(const GAS v4u*)(Cb + off - 512) : zero, uv1 = s >= 1 ? *(const GAS v4u*)(Ub + off - 512) : zero;
        const v4u cv2 = s >= 2 ? *(const GAS v4u*)(Cb + off - 1024) : zero, uv2 = s >= 2 ? *(const GAS v4u*)(Ub + off - 1024) : zero;
        float y[8]; float ssq = 0.f;
#pragma unroll
        for (int j = 0; j < 8; ++j) {
            const unsigned bw = bv[j >> 1], c0w = cv0[j >> 1], u0w = uv0[j >> 1], c1w = cv1[j >> 1], u1w = uv1[j >> 1], c2w = cv2[j >> 1], u2w = uv2[j >> 1];
            const bool hi = j & 1;
            const float bb = hi ? bfhi(bw) : bflo(bw);
            const float p0 = (hi ? bfhi(c0w) : bflo(c0w)) * (hi ? bfhi(u0w) : bflo(u0w));
            const float p1 = (hi ? bfhi(c1w) : bflo(c1w)) * (hi ? bfhi(u1w) : bflo(u1w));
            const float p2 = (hi ? bfhi(c2w) : bflo(c2w)) * (hi ? bfhi(u2w) : bflo(u2w));
            y[j] = bb * (w0[j] * p2 + w1[j] * p1 + w2[j] * p0);
            ssq += y[j] * y[j];
        }
        ssq = wave_sum(ssq);
        const float r = 1.f / sqrtf(ssq * (1.f / DC) + EPS);
        v4u o; o.x = pk2(y[0] * r * gc[0], y[1] * r * gc[1]); o.y = pk2(y[2] * r * gc[2], y[3] * r * gc[3]); o.z = pk2(y[4] * r * gc[4], y[5] * r * gc[5]); o.w = pk2(y[6] * r * gc[6], y[7] * r * gc[7]);
        *(GAS v4u*)(F.RB + (size_t)row * D + DA + c0) = o;
    }
}
__device__ __forceinline__ void p5_xattn_naive(Frame& F) {
    LAS float* qbuf = (LAS float*)(F.lds + RING_OFF) + F.wave * 512;
    LAS float* pbuf = qbuf + 256;
    const int gw = F.vcu * NWAVES + F.wave, NGW = F.G * NWAVES, lane = F.lane;
    for (int it = gw; it < M * 4; it += NGW) {
        const int row = it >> 2, hd = it & 3, b = row >> 11;
        { const unsigned long long qq = *(const GAS unsigned long long*)(F.RB + (size_t)row * D + hd * 256 + lane * 4);
          const unsigned lo = (unsigned)qq, hi = (unsigned)(qq >> 32);
          *(LAS f32x4*)(qbuf + lane * 4) = (f32x4){bflo(lo), bfhi(lo), bflo(hi), bfhi(hi)}; }
        LDS_WAIT(); asm volatile("" ::: "memory");
        float sc[4];
#pragma unroll
        for (int g = 0; g < 4; ++g) {
            const bf16* kr = F.KVM + (size_t)(b * 256 + lane + 64 * g) * 2048 + hd * 256;
            float dot = 0.f;
#pragma unroll 4
            for (int c = 0; c < 32; ++c) {
                const v4u kv = *(const GAS v4u*)(kr + c * 8);
                const f32x4 q0 = *(const LAS f32x4*)(qbuf + c * 8), q1 = *(const LAS f32x4*)(qbuf + c * 8 + 4);
                dot += (q0.x * bflo(kv.x) + q0.y * bfhi(kv.x)) + (q0.z * bflo(kv.y) + q0.w * bfhi(kv.y)) + (q1.x * bflo(kv.z) + q1.y * bfhi(kv.z)) + (q1.z * bflo(kv.w) + q1.w * bfhi(kv.w));
            }
            sc[g] = dot;
        }
        const float mx = wave_max(fmaxf(fmaxf(sc[0], sc[1]), fmaxf(sc[2], sc[3])));
        float sum = 0.f;
#pragma unroll
        for (int g = 0; g < 4; ++g) { const float p = exp2f(sc[g] - mx); pbuf[lane + 64 * g] = p; sum += p; }
        sum = wave_sum(sum);
        LDS_WAIT(); asm volatile("" ::: "memory");
        float a0 = 0.f, a1 = 0.f, a2 = 0.f, a3 = 0.f;
        const bf16* vr = F.KVM + (size_t)(b * 256) * 2048 + 1024 + hd * 256 + lane * 4;
#pragma unroll 8
        for (int k = 0; k < 256; ++k) {
            const unsigned long long vv = *(const GAS unsigned long long*)(vr + (size_t)k * 2048);
            const unsigned lo = (unsigned)vv, hi = (unsigned)(vv >> 32); const float p = pbuf[k];
            a0 += p * bflo(lo); a1 += p * bfhi(lo); a2 += p * bflo(hi); a3 += p * bfhi(hi);
        }
        const float inv = 1.f / sum;
        *(GAS unsigned long long*)(F.RC + (size_t)row * D + hd * 256 + lane * 4) = (unsigned long long)pk2(a0 * inv, a1 * inv) | ((unsigned long long)pk2(a2 * inv, a3 * inv) << 32);
        LDS_WAIT(); asm volatile("" ::: "memory");
    }
}
__device__ __forceinline__ void p8_ffn_act(Frame& F) {
    constexpr int CH = DFF / 8;
    const long total = (long)M * CH, nthr = (long)F.G * NWAVES * 64;
    for (long idx = (long)F.vcu * NWAVES * 64 + F.tid; idx < total; idx += nthr) {
        const int row = (int)(idx / CH), ch = (int)(idx % CH), s = row & 2047, c0 = ch * 8;
        const size_t off = (size_t)row * DFF + c0;
        const v4u zero = {0u, 0u, 0u, 0u};
        const v4u g0 = *(const GAS v4u*)(F.Gb + off);
        const v4u g1 = s >= 1 ? *(const GAS v4u*)(F.Gb + off - DFF) : zero;
        const v4u g2 = s >= 2 ? *(const GAS v4u*)(F.Gb + off - 2 * DFF) : zero;
        const v4u uu = *(const GAS v4u*)(F.Ub + off);
        float a[8];
#pragma unroll
        for (int j = 0; j < 8; ++j) {
            const bool hi = j & 1;
            const float x0 = hi ? bfhi(g0[j >> 1]) : bflo(g0[j >> 1]), x1 = hi ? bfhi(g1[j >> 1]) : bflo(g1[j >> 1]), x2 = hi ? bfhi(g2[j >> 1]) : bflo(g2[j >> 1]);
            const float uj = hi ? bfhi(uu[j >> 1]) : bflo(uu[j >> 1]);
            const float cv = F.ffn_cw[c0 + j] * x2 + F.ffn_cw[DFF + c0 + j] * x1 + F.ffn_cw[2 * DFF + c0 + j] * x0;
            a[j] = cv / (1.f + __expf(-cv)) * uj;
        }
        v4u o; o.x = pk2(a[0], a[1]); o.y = pk2(a[2], a[3]); o.z = pk2(a[4], a[5]); o.w = pk2(a[6], a[7]);
        *(GAS v4u*)(F.Ub + off) = o;
    }
}
__device__ __forceinline__ void p10_final(Frame& F) {
    const int gw = F.vcu * NWAVES + F.wave, NGW = F.G * NWAVES, lane = F.lane;
    f32x4 gv[4];
#pragma unroll
    for (int j = 0; j < 4; ++j) gv[j] = ((const GAS f32x4*)F.g_fin)[lane + 64 * j];
    for (int row = gw; row < M; row += NGW) {
        const float r = 1.f / sqrtf(F.ss3[row] * (1.f / D) + EPS);
        GAS f32x4* xr = (GAS f32x4*)(F.out + (size_t)row * D) + lane;
#pragma unroll
        for (int j = 0; j < 4; ++j) { f32x4 v = xr[64 * j]; v = v * r * gv[j]; xr[64 * j] = v; }
    }
}

struct Args { const float* in[18]; float* out; unsigned char* ws; int ph_lo, ph_hi, li, pad; };
__global__ void __launch_bounds__(NWAVES * 64, 2) fwd_kernel(Args args) {
    extern __shared__ __attribute__((aligned(16))) unsigned char lds[];
    Frame F;
    F.lds = (LAS unsigned char*)lds;
    F.MISC = (volatile LAS unsigned*)(F.lds + MISC_OFF);
    F.tid = threadIdx.x; F.lane = F.tid & 63; F.wave = __builtin_amdgcn_readfirstlane(F.tid >> 6);
    F.G = gridDim.x; { const int bx = blockIdx.x; F.vcu = (F.G % 8 == 0) ? (bx % 8) * (F.G / 8) + bx / 8 : bx; }
    unsigned char* ws = args.ws;
    F.ctl = (gu32*)(ws + WS_CTL);
    F.x = args.in[0]; F.mem = args.in[1]; F.g_mix = args.in[2]; F.w_in = args.in[3]; F.conv_w = args.in[4]; F.g_attn = args.in[5]; F.g_conv = args.in[6]; F.w_out = args.in[7];
    F.g_mem = args.in[8]; F.g_kvn = args.in[9]; F.w_q = args.in[10]; F.w_kv = args.in[11]; F.w_o = args.in[12]; F.g_ffn = args.in[13]; F.w_up = args.in[14]; F.ffn_cw = args.in[15];
    F.w_dn = args.in[16]; F.g_fin = args.in[17]; F.out = args.out;
    F.ksum = (float*)(ws + WS_KSUM); F.ss0 = (float*)(ws + WS_SS); F.ss1 = F.ss0 + M; F.ss2 = F.ss1 + M; F.ss3 = F.ss2 + M;
    F.WinT = (bf16*)(ws + WS_WIN); F.WoutT = (bf16*)(ws + WS_WOUT); F.WqT = (bf16*)(ws + WS_WQ); F.WkvT = (bf16*)(ws + WS_WKV); F.WoT = (bf16*)(ws + WS_WO);
    F.WupT = (bf16*)(ws + WS_WUP); F.WdnT = (bf16*)(ws + WS_WDN);
    F.MN = (bf16*)(ws + WS_MN); F.KVM = (bf16*)(ws + WS_KVM); F.RB = (bf16*)(ws + WS_RB); F.RC = (bf16*)(ws + WS_RC); F.RA = (bf16*)(ws + WS_RA);
    F.Gb = (bf16*)(ws + WS_G); F.Ub = (bf16*)(ws + WS_U);
    for (int u = F.tid; u < (LDS_BYTES - LDSCTL_OFF) / 4; u += NWAVES * 64) ((LAS unsigned*)(F.lds + LDSCTL_OFF))[u] = 0u;
    __syncthreads();
    XcdBarrier bar; bar.bar = (unsigned*)(F.ctl + CW_BAR); bar.x = 0; bar.st = nullptr;
    if (N_LAUNCHES == 1) bar = xcd_barrier_post((unsigned*)(F.ctl + CW_BAR), F.MISC + 8);
#define GRID_BAR() do { if (N_LAUNCHES == 1) { xcd_barrier(bar); } } while (0)
    const int lo = args.ph_lo, hi = args.ph_hi;
#define IN(k) (lo <= (k) && (k) < hi)
#define BOTH(k) (IN(k) && IN((k) + 1))
    typedef pg8::StaticOrder SO;

    if (IN(0)) { p0_prologue(F); if (BOTH(0)) GRID_BAR(); }
    if (IN(1)) {
        { pg8::Gemm g{F.RB, F.WinT, M, NIN, D}; SO S; S.init(M, NIN, F.G, (int)blockIdx.x);
          pg8::EpiScaleBf16 E{F.RA, 512, 512, QKV_STRIDE, C2A, 1.f, F.ss0, 1.f / D, EPS, F.ksum, 2, 4, 512};
          pg8::gemm_phase<pg8::EpiScaleBf16, SO, true, true>(F.lds + RING_OFF, g, S, E); }
        { pg8::Gemm g{F.MN, F.WkvT, MM, 2 * D, D}; SO S; S.init(MM, 2 * D, F.G, (int)blockIdx.x);
          pg8::EpiScaleBf16 E{F.KVM, 2 * D, 0, 0, 1.f, 1.f, nullptr, 0.f, 0.f, nullptr, 0, 0, 0};
          pg8::gemm_phase<pg8::EpiScaleBf16, SO, true, true>(F.lds + RING_OFF, g, S, E); }
        if (BOTH(1)) GRID_BAR();
    }
    if (IN(2)) { p2_moba_naive(F); p2_conv(F); if (BOTH(2)) GRID_BAR(); }
    if (IN(3)) {
        pg8::Gemm g{F.RB, F.WoutT, M, D, D}; SO S; S.init(M, D, F.G, (int)blockIdx.x);
        pg8::EpiResid E{F.x, F.out, D, F.RC, F.ss1};
        pg8::gemm_phase<pg8::EpiResid, SO, true, true>(F.lds + RING_OFF, g, S, E);
        if (BOTH(3)) GRID_BAR();
    }
    if (IN(4)) {
        pg8::Gemm g{F.RC, F.WqT, M, D, D}; SO S; S.init(M, D, F.G, (int)blockIdx.x);
        pg8::EpiScaleBf16 E{F.RB, D, 0, 0, C2M, C2M, F.ss1, 1.f / D, EPS, nullptr, 0, 0, 0};
        pg8::gemm_phase<pg8::EpiScaleBf16, SO, true, true>(F.lds + RING_OFF, g, S, E);
        if (BOTH(4)) GRID_BAR();
    }
    if (IN(5)) { p5_xattn_naive(F); if (BOTH(5)) GRID_BAR(); }
    if (IN(6)) {
        pg8::Gemm g{F.RC, F.WoT, M, D, D}; SO S; S.init(M, D, F.G, (int)blockIdx.x);
        pg8::EpiResid E{F.out, F.out, D, F.RB, F.ss2};
        pg8::gemm_phase<pg8::EpiResid, SO, true, true>(F.lds + RING_OFF, g, S, E);
        if (BOTH(6)) GRID_BAR();
    }
    if (IN(7)) {
        pg8::Gemm g{F.RB, F.WupT, M, NUP, D}; SO S; S.init(M, NUP, F.G, (int)blockIdx.x);
        pg8::EpiUpSplit E{F.Gb, F.Ub, DFF, F.ss2, 1.f / D, EPS};
        pg8::gemm_phase<pg8::EpiUpSplit, SO, true, true>(F.lds + RING_OFF, g, S, E);
        if (BOTH(7)) GRID_BAR();
    }
    if (IN(8)) { p8_ffn_act(F); if (BOTH(8)) GRID_BAR(); }
    if (IN(9)) {
        pg8::Gemm g{F.Ub, F.WdnT, M, D, DFF}; SO S; S.init(M, D, F.G, (int)blockIdx.x);
        pg8::EpiResid E{F.out, F.out, D, nullptr, F.ss3};
        pg8::gemm_phase<pg8::EpiResid, SO, true, true>(F.lds + RING_OFF, g, S, E);
        if (BOTH(9)) GRID_BAR();
    }
    if (IN(10)) { p10_final(F); }
#undef IN
#undef BOTH
}

extern "C" void kernel_launch(void* const* d_in, const int* in_sizes, int n_in, void* d_out, int out_size, void* d_ws, size_t ws_size, hipStream_t stream) {
    static int grid = 0;
    if (grid == 0) {
        if (n_in != 18 || in_sizes[0] != M * D || out_size != M * D || ws_size < WS_END) {
            fprintf(stderr, "kernel_launch: built for 18 inputs, x/out of %d floats, >= %zu bytes of workspace; got n_in %d, in0 %d, out %d, ws %zu; nothing launched\n", M * D, (size_t)WS_END, n_in, n_in > 0 ? in_sizes[0] : -1, out_size, ws_size); grid = -1; return; }
        int dev = 0, cus = 0, per_cu = 0;
        if (hipGetDevice(&dev) != hipSuccess || hipDeviceGetAttribute(&cus, hipDeviceAttributeMultiprocessorCount, dev) != hipSuccess) { fprintf(stderr, "kernel_launch: device query failed\n"); grid = -1; return; }
        if (hipFuncSetAttribute((const void*)fwd_kernel, hipFuncAttributeMaxDynamicSharedMemorySize, LDS_BYTES) != hipSuccess) { fprintf(stderr, "kernel_launch: hipFuncSetAttribute failed\n"); grid = -1; return; }
        if (hipOccupancyMaxActiveBlocksPerMultiprocessor(&per_cu, (const void*)fwd_kernel, NWAVES * 64, LDS_BYTES) != hipSuccess || per_cu < 1)
            fprintf(stderr, "kernel_launch: note: occupancy query reports %d workgroups per CU\n", per_cu);
        (void)hipGetLastError();
        grid = cus;
        if (grid > 256) grid = 256;
    }
    if (grid < 0) return;
    if (hipMemsetAsync((char*)d_ws + WS_CTL, 0, CTL_ZERO_BYTES, stream) != hipSuccess) { fprintf(stderr, "kernel_launch: hipMemsetAsync failed\n"); return; }
    Args a{};
    for (int i = 0; i < 18; ++i) a.in[i] = (const float*)d_in[i];
    a.out = (float*)d_out; a.ws = (unsigned char*)d_ws;
    for (int li = 0; li < N_LAUNCHES; ++li) {
        a.ph_lo = (N_LAUNCHES == 1) ? 0 : li; a.ph_hi = (N_LAUNCHES == 1) ? N_PHASES : li + 1; a.li = li;
        hipLaunchKernelGGL(fwd_kernel, dim3(grid), dim3(NWAVES * 64), LDS_BYTES, stream, a);
        const hipError_t le = hipPeekAtLastError();
        if (le != hipSuccess) { fprintf(stderr, "kernel_launch: launch %d failed: %s\n", li, hipGetErrorName(le)); break; }
    }
}
```
